# Optimizing an MI355X kernel written in HIP

```python
import math
import jax, jax.numpy as jnp
from jax import lax
import numpy as np

D_MODEL = 1024
BATCH = 2
SEQ = 8192
DEPTH = 1

MIX_WIDTH = D_MODEL
ATTN_WIDTH = MIX_WIDTH // 2
POOL_WIDTH = MIX_WIDTH - ATTN_WIDTH

HEAD_DIM = 64
N_HEADS = ATTN_WIDTH // HEAD_DIM
N_KV_HEADS = 2
GROUP = N_HEADS // N_KV_HEADS
KV_WIDTH = N_KV_HEADS * HEAD_DIM
WINDOW = 128
BLOCK = 128
ROPE_THETA = 10000.0

POOL_WINDOWS = (2, 4, 8, 16)
N_POOL_GROUPS = len(POOL_WINDOWS)
POOL_GROUP_WIDTH = POOL_WIDTH // N_POOL_GROUPS

IN_PROJ_WIDTH = ATTN_WIDTH + 2 * KV_WIDTH + POOL_WIDTH

FFN_MULT_OF = 256
D_FF = ((8 * D_MODEL // 3 + FFN_MULT_OF - 1) // FFN_MULT_OF) * FFN_MULT_OF

N_MOD = 6
RMS_EPS = 1e-6

kernel_name = "hymba_pool_swa_sink_adaln_block"


def rmsnorm(x, g):
    xf = x.astype(jnp.float32)
    y = xf * lax.rsqrt(jnp.mean(xf * xf, axis=-1, keepdims=True) + RMS_EPS)
    return (y * g.astype(jnp.float32)).astype(x.dtype)


def modulate(h, shift, scale):
    return h * (1.0 + scale[:, None, :]) + shift[:, None, :]


def apply_rope(t, positions):
    half = HEAD_DIM // 2
    inv_freq = ROPE_THETA ** (-jnp.arange(half, dtype=jnp.float32) * (2.0 / HEAD_DIM))
    ang = positions.astype(jnp.float32)[:, :, None] * inv_freq[None, None, :]
    cos = jnp.cos(ang)[:, :, None, :]
    sin = jnp.sin(ang)[:, :, None, :]
    tf = t.astype(jnp.float32)
    t1, t2 = tf[..., :half], tf[..., half:]
    out = jnp.concatenate([t1 * cos - t2 * sin, t2 * cos + t1 * sin], axis=-1)
    return out.astype(t.dtype)


def sliding_window_attention_with_sinks(q, k, v, sinks):
    b, s = q.shape[0], q.shape[1]
    nb = s // BLOCK
    qb = q.reshape(b, nb, BLOCK, N_KV_HEADS, GROUP, HEAD_DIM)

    def with_prev_block(t):
        tb = t.reshape(b, nb, BLOCK, N_KV_HEADS, HEAD_DIM)
        prev = jnp.pad(tb, ((0, 0), (1, 0), (0, 0), (0, 0), (0, 0)))[:, :nb]
        return jnp.concatenate([prev, tb], axis=2)

    kk = with_prev_block(k)
    vv = with_prev_block(v)

    scale = 1.0 / math.sqrt(HEAD_DIM)
    logits = jnp.einsum('bnqhgd,bnkhd->bnhgqk', qb.astype(jnp.float32), kk.astype(jnp.float32)) * scale

    qi = jnp.arange(BLOCK)[:, None]
    kj = jnp.arange(2 * BLOCK)[None, :]
    rel = kj - BLOCK - qi
    band = (rel <= 0) & (rel > -WINDOW)
    not_pad = (jnp.arange(nb)[:, None] > 0) | (jnp.arange(2 * BLOCK)[None, :] >= BLOCK)
    mask = band[None, :, :] & not_pad[:, None, :]
    logits = jnp.where(mask[None, :, None, None, :, :], logits, -jnp.inf)

    sink = sinks.astype(jnp.float32).reshape(N_KV_HEADS, GROUP)[None, None, :, :, None, None]
    m = jnp.maximum(jnp.max(logits, axis=-1, keepdims=True), sink)
    p = jnp.exp(logits - m)
    denom = jnp.sum(p, axis=-1, keepdims=True) + jnp.exp(sink - m)
    out = jnp.einsum('bnhgqk,bnkhd->bnqhgd', p / denom, vv.astype(jnp.float32))
    return out.reshape(b, s, N_HEADS * HEAD_DIM).astype(q.dtype)


def multiscale_pool_mixer(u, w_pool, pool_scale):
    s = u.shape[1]
    outs = []
    for gi, w in enumerate(POOL_WINDOWS):
        ug = u[..., gi * POOL_GROUP_WIDTH:(gi + 1) * POOL_GROUP_WIDTH]
        uf = ug.astype(jnp.float32)
        cs = jnp.cumsum(uf, axis=1)
        shifted = jnp.pad(cs, ((0, 0), (w, 0), (0, 0)))[:, :s]
        count = jnp.minimum(jnp.arange(s) + 1, w).astype(jnp.float32)
        mean = (cs - shifted) / count[None, :, None]
        pooled = (mean - uf).astype(u.dtype)
        outs.append(jnp.einsum('bsc,cd->bsd', pooled, w_pool[gi]))
    return jnp.concatenate(outs, axis=-1) * pool_scale


def setup_inputs(seed: int = 0) -> dict:
    key = jax.random.key(seed)
    ks = jax.random.split(key, 20)
    f32 = jnp.float32
    x = jax.random.normal(ks[0], (BATCH, SEQ, D_MODEL), f32)
    c = jax.random.normal(ks[1], (BATCH, D_MODEL), f32)
    offsets = jax.random.randint(ks[2], (BATCH, 1), 0, 1024, dtype=jnp.int32)
    positions = offsets + jnp.arange(SEQ, dtype=jnp.int32)[None, :]
    w_ada = jax.random.normal(ks[3], (D_MODEL, N_MOD * D_MODEL), f32) * (D_MODEL ** -0.5) * 0.5
    b_ada = jax.random.normal(ks[4], (N_MOD * D_MODEL,), f32) * 0.02
    norm1 = 1.0 + 0.05 * jax.random.normal(ks[5], (D_MODEL,), f32)
    w_in = jax.random.normal(ks[6], (D_MODEL, IN_PROJ_WIDTH), f32) * (D_MODEL ** -0.5)
    sinks = jax.random.normal(ks[7], (N_HEADS,), f32) * 0.5
    w_pool = jax.random.normal(ks[8], (N_POOL_GROUPS, POOL_GROUP_WIDTH, POOL_GROUP_WIDTH), f32) * (POOL_GROUP_WIDTH ** -0.5)
    pool_scale = 1.0 + 0.1 * jax.random.normal(ks[9], (POOL_WIDTH,), f32)
    w_out = jax.random.normal(ks[10], (MIX_WIDTH, D_MODEL), f32) * (MIX_WIDTH ** -0.5)
    norm2 = 1.0 + 0.05 * jax.random.normal(ks[11], (D_MODEL,), f32)
    w_gate = jax.random.normal(ks[12], (D_MODEL, D_FF), f32) * (D_MODEL ** -0.5)
    w_up = jax.random.normal(ks[13], (D_MODEL, D_FF), f32) * (D_MODEL ** -0.5)
    w_down = jax.random.normal(ks[14], (D_FF, D_MODEL), f32) * (D_FF ** -0.5)
    norm_f = 1.0 + 0.05 * jax.random.normal(ks[15], (D_MODEL,), f32)
    return {"x": x, "c": c, "positions": positions, "w_ada": w_ada, "b_ada": b_ada,
            "norm1": norm1, "w_in": w_in, "sinks": sinks, "w_pool": w_pool,
            "pool_scale": pool_scale, "w_out": w_out, "norm2": norm2,
            "w_gate": w_gate, "w_up": w_up, "w_down": w_down, "norm_f": norm_f}


def reference(x, c, positions, w_ada, b_ada, norm1, w_in, sinks, w_pool, pool_scale,
              w_out, norm2, w_gate, w_up, w_down, norm_f):
    b, s, _ = x.shape
    mod = jax.nn.silu(c) @ w_ada + b_ada
    shift1, scale1, gate1, shift2, scale2, gate2 = jnp.split(mod, N_MOD, axis=-1)

    for _ in range(DEPTH):
        h = modulate(rmsnorm(x, norm1), shift1, scale1)
        u = h @ w_in
        q = u[..., :ATTN_WIDTH].reshape(b, s, N_HEADS, HEAD_DIM)
        k = u[..., ATTN_WIDTH:ATTN_WIDTH + KV_WIDTH].reshape(b, s, N_KV_HEADS, HEAD_DIM)
        v = u[..., ATTN_WIDTH + KV_WIDTH:ATTN_WIDTH + 2 * KV_WIDTH].reshape(b, s, N_KV_HEADS, HEAD_DIM)
        u_pool = u[..., ATTN_WIDTH + 2 * KV_WIDTH:]

        q = apply_rope(q, positions)
        k = apply_rope(k, positions)
        attn_out = sliding_window_attention_with_sinks(q, k, v, sinks)
        pool_out = multiscale_pool_mixer(u_pool, w_pool, pool_scale)

        mixed = jnp.concatenate([attn_out, pool_out], axis=-1) @ w_out
        x = x + gate1[:, None, :] * mixed

        h2 = modulate(rmsnorm(x, norm2), shift2, scale2)
        ff = (jax.nn.silu(h2 @ w_gate) * (h2 @ w_up)) @ w_down
        x = x + gate2[:, None, :] * ff

    return rmsnorm(x, norm_f)
```

```cpp
#include <hip/hip_runtime.h>
#include <cstdio>
#include <cstdint>
namespace pg8 {
#define PG8_LAS __attribute__((address_space(3)))
typedef unsigned short bf16_t;
typedef short bf16x8 __attribute__((ext_vector_type(8)));
typedef float f32x4 __attribute__((ext_vector_type(4)));
typedef unsigned u32x4 __attribute__((ext_vector_type(4)));
constexpr int BM = 256, BK = 64, HALF = 128, HTB = HALF * BK * 2  , STAGE_BYTES = 8 * HTB, NXCD = 8, WGM = 8;

__host__ __device__ __forceinline__ int lds_byte(int r, int c) { const int st = (r >> 4) * 2 + (c >> 5), rr = r & 15, cc = c & 31, ob = rr * 64 + cc * 2; return st * 1024 + (ob ^ (((ob >> 9) & 1) << 5)); }
__host__ __device__ __forceinline__ void stage_rc(int b, int& R, int& C) { const int st = b / 1024, sb = b % 1024, swz = sb ^ (((sb >> 9) & 1) << 5); R = (st >> 1) * 16 + swz / 64; C = (st & 1) * 32 + (swz % 64) / 2; }
__host__ __device__ __forceinline__ int perm32(int rho) { const int n = rho >> 4, i = rho & 15; return 8 * (i >> 2) + 4 * n + (i & 3); }

struct Unit { int pm, pn; };
struct Gemm { const bf16_t* A; const bf16_t* Bt; int M, N, K; };

struct StaticOrder {
    int nM, nN, nwg, G, c;
    __host__ __device__ void init(int M, int N, int G_, int c_) { nM = M / BM; nN = N / BM; nwg = nM * nN; G = G_; c = c_; }
    __host__ __device__ bool next(int i, Unit& u) const {
        const long L = (long)i * G + c; if (L >= nwg) return false;
        int wgid = (int)L; { const int q = nwg / NXCD, r = nwg % NXCD, xcd = wgid % NXCD, off = wgid / NXCD; wgid = (xcd < r ? xcd * (q + 1) : r * (q + 1) + (xcd - r) * q) + off; }
        const int nig = WGM * nN, gid = wgid / nig, fm = gid * WGM, gsz = (nM - fm) < WGM ? (nM - fm) : WGM;
        u.pm = fm + ((wgid % nig) % gsz); u.pn = (wgid % nig) / gsz; return true;
    }
    __device__ __forceinline__ void a_ready(const Unit&) const {}
    __device__ __forceinline__ void done(const Unit&) const {}
};

__device__ __forceinline__ unsigned cvt_pk_bf16(float lo, float hi) { unsigned r; asm volatile("v_cvt_pk_bf16_f32 %0, %1, %2" : "=v"(r) : "v"(lo), "v"(hi)); return r; }

struct EpiStoreBf16 {
    static constexpr bool PERM = true, AFTER_DRAIN = false;
    bf16_t* O; int ldc;
    __device__ __forceinline__ void operator()(const f32x4 (&acc)[2][2][4][2], const Unit& u, int wr, int wc, int fr, int fq) const {
        const int row0 = u.pm * BM + wr * 64 + fr, col0 = u.pn * BM + wc * 32 + 8 * fq;
#pragma unroll
        for (int ai = 0; ai < 2; ++ai)
#pragma unroll
            for (int m = 0; m < 4; ++m) { bf16_t* rowp = O + (size_t)(row0 + ai * HALF + m * 16) * ldc + col0;
#pragma unroll
                for (int bj = 0; bj < 2; ++bj) { const f32x4 v0 = acc[ai][bj][m][0], v1 = acc[ai][bj][m][1];
                    u32x4 w; w.x = cvt_pk_bf16(v0[0], v0[1]); w.y = cvt_pk_bf16(v0[2], v0[3]); w.z = cvt_pk_bf16(v1[0], v1[1]); w.w = cvt_pk_bf16(v1[2], v1[3]);
                    *(u32x4*)(rowp + bj * HALF) = w; } }
    }
};
__device__ __forceinline__ float silu_mul(float g, float u) { return g * u * __builtin_amdgcn_rcpf(1.0f + __builtin_amdgcn_exp2f(-1.4426950408889634f * g)); }
struct EpiSwiGLU {
    static constexpr bool PERM = true, AFTER_DRAIN = false;
    bf16_t* O; int ldc;
    __device__ __forceinline__ void operator()(const f32x4 (&acc)[2][2][4][2], const Unit& u, int wr, int wc, int fr, int fq) const {
        const int row0 = u.pm * BM + wr * 64 + fr, col0 = u.pn * HALF + wc * 32 + 8 * fq;
#pragma unroll
        for (int ai = 0; ai < 2; ++ai)
#pragma unroll
            for (int m = 0; m < 4; ++m) { bf16_t* rowp = O + (size_t)(row0 + ai * HALF + m * 16) * ldc + col0;
                const f32x4 g0 = acc[ai][0][m][0], g1 = acc[ai][0][m][1], u0 = acc[ai][1][m][0], u1 = acc[ai][1][m][1];
                u32x4 w; w.x = cvt_pk_bf16(silu_mul(g0[0], u0[0]), silu_mul(g0[1], u0[1])); w.y = cvt_pk_bf16(silu_mul(g0[2], u0[2]), silu_mul(g0[3], u0[3]));
                w.z = cvt_pk_bf16(silu_mul(g1[0], u1[0]), silu_mul(g1[1], u1[1])); w.w = cvt_pk_bf16(silu_mul(g1[2], u1[2]), silu_mul(g1[3], u1[3]));
                *(u32x4*)rowp = w; }
    }
};
struct EpiResGateF32 {
    static constexpr bool PERM = false, AFTER_DRAIN = false;
    const float* base; float* out; const float* gate; int gate_pitch; int ldc; int rows_per_batch;
    __device__ __forceinline__ void operator()(const f32x4 (&acc)[2][2][4][2], const Unit& u, int wr, int wc, int fr, int fq) const {
        const int row0 = u.pm * BM + wr * 64 + fr, col0 = u.pn * BM + wc * 32 + 4 * fq;
        const float* gp = gate + (size_t)((u.pm * BM) / rows_per_batch) * gate_pitch + col0;
        f32x4 gv[2][2];
#pragma unroll
        for (int bj = 0; bj < 2; ++bj)
#pragma unroll
            for (int n = 0; n < 2; ++n) gv[bj][n] = *(const f32x4*)(gp + bj * HALF + n * 16);
#pragma unroll
        for (int ai = 0; ai < 2; ++ai)
#pragma unroll
            for (int m = 0; m < 4; ++m) { const size_t off = (size_t)(row0 + ai * HALF + m * 16) * ldc + col0;
#pragma unroll
                for (int bj = 0; bj < 2; ++bj)
#pragma unroll
                    for (int n = 0; n < 2; ++n) { const f32x4 bs = *(const f32x4*)(base + off + bj * HALF + n * 16); *(f32x4*)(out + off + bj * HALF + n * 16) = bs + gv[bj][n] * acc[ai][bj][m][n]; } }
    }
};

template <class Epi, class Sched, bool ALIGN_EPI = false, bool SP2 = false>
__device__ __forceinline__ void gemm_phase(PG8_LAS unsigned char* lds, const Gemm g, const Sched& S, const Epi& E) {
    const int tid = threadIdx.x, wid = __builtin_amdgcn_readfirstlane(tid >> 6), lane = tid & 63, wr = wid >> 2, wc = wid & 3, fr = lane & 15, fq = lane >> 4;
    const int K = g.K, nt = K / BK;
    unsigned voffA[2], voffB[2];
#pragma unroll
    for (int i = 0; i < 2; ++i) { int R, C; stage_rc(tid * 16 + i * 8192, R, C); const int Rb = Epi::PERM ? ((R & ~31) + perm32(R & 31)) : R;
        voffA[i] = (unsigned)(R * K + C) * 2u; voffB[i] = (unsigned)(Rb * K + C) * 2u; }
    const size_t kstep = (size_t)(BK * 2);
    const size_t hstep = (size_t)HALF * K * 2;
    const size_t tstep = 2 * hstep;
    const unsigned ldsw = (unsigned)wid * 1024u;
    const int aoff = lds_byte(wr * 64 + fr, fq * 8), boff = lds_byte(wc * 32 + fr, fq * 8);
#define PG8_SA(b, h) (((b) * 2 + (h)) * HTB)
#define PG8_SB(b, h) ((4 + (b) * 2 + (h)) * HTB)
#define PG8_STAGE(bufoff, gbase, voff) do { _Pragma("unroll") for (int _i = 0; _i < 2; ++_i) \
        __builtin_amdgcn_global_load_lds((const unsigned*)((const char*)(gbase) + (voff)[_i]), (PG8_LAS unsigned*)(lds + (bufoff) + ldsw + _i * 8192), 16, 0, 0); } while (0)
#define PG8_LDA(dst, b, h) do { _Pragma("unroll") for (int m = 0; m < 4; ++m) _Pragma("unroll") for (int k = 0; k < 2; ++k) dst[m][k] = *(const PG8_LAS bf16x8*)(lds + PG8_SA(b, h) + aoff + m * 2048 + k * 1024); } while (0)
#define PG8_LDB(dst, b, h) do { _Pragma("unroll") for (int n = 0; n < 2; ++n) _Pragma("unroll") for (int k = 0; k < 2; ++k) dst[n][k] = *(const PG8_LAS bf16x8*)(lds + PG8_SB(b, h) + boff + n * 2048 + k * 1024); } while (0)
#define PG8_MMA(ai, bj, At, Bt) do { __builtin_amdgcn_s_setprio(1); _Pragma("unroll") for (int m = 0; m < 4; ++m) _Pragma("unroll") for (int n = 0; n < 2; ++n) _Pragma("unroll") for (int k = 0; k < 2; ++k) \
        acc[ai][bj][m][n] = __builtin_amdgcn_mfma_f32_16x16x32_bf16(Bt[n][k], At[m][k], acc[ai][bj][m][n], 0, 0, 0); __builtin_amdgcn_s_setprio(0); } while (0)
#define PG8_WAIT_V(n) asm volatile("s_waitcnt vmcnt(" #n ")" ::: "memory")
#define PG8_WAIT_L(n) asm volatile("s_waitcnt lgkmcnt(" #n ")" ::: "memory")
#define PG8_BAR __builtin_amdgcn_s_barrier()
#define PG8_SCHED __builtin_amdgcn_sched_barrier(0)
    Unit cur, nxt; int ui = 0;
    if (!S.next(0, cur)) return;
    f32x4 acc[2][2][4][2];
#pragma unroll
    for (int a = 0; a < 2; ++a)
#pragma unroll
        for (int b = 0; b < 2; ++b)
#pragma unroll
            for (int m = 0; m < 4; ++m)
#pragma unroll
                for (int n = 0; n < 2; ++n) acc[a][b][m][n] = (f32x4){0.f, 0.f, 0.f, 0.f};
    bf16x8 At[4][2], B0[2][2], B1[2][2];
    const char* cA = (const char*)g.A + (size_t)cur.pm * tstep; const char* cB = (const char*)g.Bt + (size_t)cur.pn * tstep;
    S.a_ready(cur);
    if constexpr (SP2) {
        PG8_STAGE(PG8_SB(0, 0), cB, voffB); PG8_STAGE(PG8_SB(0, 1), cB + hstep, voffB); PG8_STAGE(PG8_SA(0, 0), cA, voffA); PG8_STAGE(PG8_SA(0, 1), cA + hstep, voffA);
        if (wr == 1) PG8_BAR;
        PG8_WAIT_V(2); PG8_BAR;
        PG8_STAGE(PG8_SB(1, 0), cB + kstep, voffB); PG8_STAGE(PG8_SA(1, 0), cA + kstep, voffA); PG8_STAGE(PG8_SB(1, 1), cB + hstep + kstep, voffB);
        PG8_WAIT_V(6); PG8_BAR;
    } else {
        PG8_STAGE(PG8_SB(0, 0), cB, voffB); PG8_STAGE(PG8_SA(0, 0), cA, voffA); PG8_STAGE(PG8_SB(0, 1), cB + hstep, voffB); PG8_STAGE(PG8_SA(0, 1), cA + hstep, voffA);
        if (wr == 1) PG8_BAR;
        PG8_WAIT_V(4); PG8_BAR;
        PG8_STAGE(PG8_SB(1, 0), cB + kstep, voffB); PG8_STAGE(PG8_SA(1, 0), cA + kstep, voffA); PG8_STAGE(PG8_SB(1, 1), cB + hstep + kstep, voffB);
        PG8_WAIT_V(6); PG8_BAR;
    }
    for (;;) {
        const bool has_next = S.next(ui + 1, nxt);
        const char* nA = has_next ? (const char*)g.A + (size_t)nxt.pm * tstep : cA; const char* nB = has_next ? (const char*)g.Bt + (size_t)nxt.pn * tstep : cB;
        for (int t = 0; t < nt; t += 2) {
            const bool last = (t == nt - 2);
            const char* a1 = cA + (size_t)(t + 1) * kstep;
            const char* a2 = last ? nA : cA + (size_t)(t + 2) * kstep; const char* b2 = last ? nB : cB + (size_t)(t + 2) * kstep;
            const char* a3 = a2 + kstep; const char* b3 = b2 + kstep;
            if (last && has_next) S.a_ready(nxt);
            if constexpr (SP2) {
            PG8_LDB(B0, 0, 0); PG8_LDB(B1, 0, 1); PG8_SCHED; PG8_LDA(At, 0, 0); PG8_STAGE(PG8_SA(1, 1), a1 + hstep, voffA);
            PG8_WAIT_V(8); PG8_WAIT_L(0); PG8_BAR; PG8_MMA(0, 0, At, B0); PG8_MMA(0, 1, At, B1); PG8_BAR; PG8_SCHED;
            PG8_LDA(At, 0, 1); PG8_STAGE(PG8_SB(0, 0), b2, voffB); PG8_STAGE(PG8_SB(0, 1), b2 + hstep, voffB); PG8_STAGE(PG8_SA(0, 0), a2, voffA);
            PG8_WAIT_V(8); PG8_WAIT_L(0); PG8_BAR; PG8_MMA(1, 0, At, B0); PG8_MMA(1, 1, At, B1); PG8_BAR; PG8_SCHED;
            PG8_LDB(B0, 1, 0); PG8_LDB(B1, 1, 1); PG8_SCHED; PG8_LDA(At, 1, 0); PG8_STAGE(PG8_SA(0, 1), a2 + hstep, voffA);
            PG8_WAIT_V(8); PG8_WAIT_L(0); PG8_BAR; PG8_MMA(0, 0, At, B0); PG8_MMA(0, 1, At, B1); PG8_BAR; PG8_SCHED;
            PG8_LDA(At, 1, 1); PG8_STAGE(PG8_SB(1, 0), b3, voffB); PG8_STAGE(PG8_SB(1, 1), b3 + hstep, voffB); PG8_STAGE(PG8_SA(1, 0), a3, voffA);
            PG8_WAIT_V(8); PG8_WAIT_L(0); PG8_BAR; PG8_MMA(1, 0, At, B0); PG8_MMA(1, 1, At, B1); PG8_BAR; PG8_SCHED;
            } else {
            PG8_LDB(B0, 0, 0); PG8_SCHED; PG8_LDA(At, 0, 0); PG8_STAGE(PG8_SA(1, 1), a1 + hstep, voffA);
            PG8_WAIT_L(8); PG8_BAR; PG8_WAIT_L(0); PG8_MMA(0, 0, At, B0); PG8_BAR; PG8_SCHED;
            PG8_LDB(B1, 0, 1); PG8_STAGE(PG8_SB(0, 0), b2, voffB);
            PG8_BAR; PG8_WAIT_L(0); PG8_MMA(0, 1, At, B1); PG8_BAR;
            PG8_LDA(At, 0, 1); PG8_STAGE(PG8_SA(0, 0), a2, voffA);
            PG8_BAR; PG8_WAIT_L(0); PG8_MMA(1, 0, At, B0); PG8_BAR; PG8_SCHED;
            PG8_STAGE(PG8_SB(0, 1), b2 + hstep, voffB);
            PG8_WAIT_V(6); PG8_BAR; PG8_MMA(1, 1, At, B1); PG8_BAR;
            PG8_LDB(B0, 1, 0); PG8_SCHED; PG8_LDA(At, 1, 0); PG8_STAGE(PG8_SA(0, 1), a2 + hstep, voffA);
            PG8_WAIT_L(8); PG8_BAR; PG8_WAIT_L(0); PG8_MMA(0, 0, At, B0); PG8_BAR; PG8_SCHED;
            PG8_LDB(B1, 1, 1); PG8_STAGE(PG8_SB(1, 0), b3, voffB);
            PG8_BAR; PG8_WAIT_L(0); PG8_MMA(0, 1, At, B1); PG8_BAR;
            PG8_LDA(At, 1, 1); PG8_STAGE(PG8_SA(1, 0), a3, voffA);
            PG8_BAR; PG8_WAIT_L(0); PG8_MMA(1, 0, At, B0); PG8_BAR; PG8_SCHED;
            PG8_STAGE(PG8_SB(1, 1), b3 + hstep, voffB);
            PG8_WAIT_V(6); PG8_BAR; PG8_MMA(1, 1, At, B1); PG8_BAR;
            }
        }
        if constexpr (ALIGN_EPI) { if (wr == 0) PG8_BAR; }
        if constexpr (!Epi::AFTER_DRAIN) { E(acc, cur, wr, wc, fr, fq); S.done(cur); }
        if (!has_next) break;
#pragma unroll
        for (int a = 0; a < 2; ++a)
#pragma unroll
            for (int b = 0; b < 2; ++b)
#pragma unroll
                for (int m = 0; m < 4; ++m)
#pragma unroll
                    for (int n = 0; n < 2; ++n) acc[a][b][m][n] = (f32x4){0.f, 0.f, 0.f, 0.f};
        cur = nxt; cA = nA; cB = nB; ++ui;
        if constexpr (ALIGN_EPI) { if (wr == 1) PG8_BAR; }
    }
    PG8_WAIT_V(0);
    if constexpr (!ALIGN_EPI) { if (wr == 0) PG8_BAR; }
    PG8_BAR;
    if constexpr (Epi::AFTER_DRAIN) { E.fused(acc, cur, wr, wc, fr, fq, lds, wid, lane); S.done(cur); }
#undef PG8_SA
#undef PG8_SB
#undef PG8_STAGE
#undef PG8_LDA
#undef PG8_LDB
#undef PG8_MMA
#undef PG8_WAIT_V
#undef PG8_WAIT_L
#undef PG8_BAR
#undef PG8_SCHED
}
}

#ifndef PG8_SP2
#define PG8_SP2 true
#endif
#ifndef PG8_ALIGN
#define PG8_ALIGN true
#endif
constexpr int NWAVES = 8;
constexpr int BATCH = 2, SEQ = 8192, D = 1024, M = BATCH * SEQ;
constexpr int NQ = 512, NKV = 128, NPOOL = 512, NIN = NQ + 2 * NKV + NPOOL;
constexpr int COL_K = NQ, COL_V = NQ + NKV, COL_P = NQ + 2 * NKV;
constexpr int HD = 64, NH = 8, NKVH = 2, GROUP = 4, WINDOW = 128;
constexpr int FF = 2816, NGU = 2 * FF;
constexpr int NMOD = 6 * D;
constexpr float RMS_EPS = 1e-6f;
constexpr float C2 = 0.125f * 1.4426950408889634f;
constexpr size_t MiB = 1u << 20;
constexpr size_t WS_CTL = 0, CTL_ZERO_BYTES = 1 * MiB;
constexpr size_t WS_WIN = 2 * MiB;
constexpr size_t WS_WCAT = 5 * MiB;
constexpr size_t WS_WGU = 8 * MiB;
constexpr size_t WS_WD = 20 * MiB;
constexpr size_t WS_ROPE = 26 * MiB;
constexpr size_t WS_MODP = 30 * MiB;
constexpr size_t WS_MODF = 31 * MiB;
constexpr size_t WS_XN = 32 * MiB;
constexpr size_t WS_U = 64 * MiB;
constexpr size_t WS_CAT = 104 * MiB;
constexpr size_t WS_H = 136 * MiB;
constexpr size_t WS_END = 224 * MiB;
constexpr int CW_TMO = 0, CW_CODE = 1, CW_BAR = 4096;
constexpr int RING_OFF = 0, RING_BYTES = 131072;
constexpr int LDSCTL_OFF = RING_BYTES, MISC_OFF = LDSCTL_OFF + 320;
constexpr int LDS_BYTES = 147456;

#define GAS __attribute__((address_space(1)))
#define LAS __attribute__((address_space(3)))
typedef unsigned short bf16;
typedef unsigned v4u __attribute__((ext_vector_type(4)));
typedef float f32x4 __attribute__((ext_vector_type(4)));
typedef short bf16x8 __attribute__((ext_vector_type(8)));
typedef GAS unsigned gu32;
typedef GAS unsigned long long gu64;
#define RLX_AGENT __ATOMIC_RELAXED, __HIP_MEMORY_SCOPE_AGENT
#define LDS_WAIT() asm volatile("s_waitcnt lgkmcnt(0)" ::: "memory")
#define VM_WAIT() asm volatile("s_waitcnt vmcnt(0)" ::: "memory")
__device__ __forceinline__ unsigned long long rt() { return __builtin_amdgcn_s_memrealtime(); }
__device__ __forceinline__ unsigned f2bf(float f) { unsigned u = __builtin_bit_cast(unsigned, f); return (u + 0x7fffu + ((u >> 16) & 1u)) >> 16; }
__device__ __forceinline__ unsigned pk2(float lo, float hi) { return f2bf(lo) | (f2bf(hi) << 16); }

#define XB_TMO      128
#define XB_XCNT(j)  (256  + 64 * (j))
#define XB_XSUB(j)  (1280 + 64 * (j))
#define XB_XGEN(j)  (2304 + 64 * (j))
#define XB_TOP      3328
#define XB_TOPGEN   3392
#define XCD_BAR_WORDS 3456
#define XB_SPIN_CAP (1u << 18)

__device__ __forceinline__ unsigned xb_ld(unsigned* p)              { return __hip_atomic_load(p, __ATOMIC_RELAXED, __HIP_MEMORY_SCOPE_AGENT); }
__device__ __forceinline__ unsigned xb_add(unsigned* p, unsigned v) { return __hip_atomic_fetch_add(p, v, __ATOMIC_RELAXED, __HIP_MEMORY_SCOPE_AGENT); }
__device__ __forceinline__ unsigned xb_xcc_id() { return (unsigned)__builtin_amdgcn_s_getreg((3 << 11) | 20) & 0xFu; }
#define XB_SPIN(cond, bar) do { unsigned _sp = 0; while (cond) { __builtin_amdgcn_s_sleep(1); \
    if ((++_sp & 255u) == 0u) { if (xb_ld(&(bar)[XB_TMO])) break; if (_sp > XB_SPIN_CAP) { atomicAdd(&(bar)[XB_TMO], 1u); break; } } } } while (0)

struct XcdBarrier {
    unsigned* bar; unsigned x;
    volatile LAS unsigned* st;
};

__device__ __forceinline__ XcdBarrier xcd_barrier_post(unsigned* bar, volatile LAS unsigned* st) {
    XcdBarrier b; b.bar = bar; b.x = xb_xcc_id(); b.st = st;
    if (threadIdx.x == 0) (void)xb_add(&bar[XB_XCNT(b.x)], 1u);
    return b;
}
__device__ __forceinline__ void xcd_barrier_complete(unsigned* bar, unsigned x, unsigned& nloc, unsigned& nx) {
    const unsigned G = gridDim.x * gridDim.y * gridDim.z;
    unsigned sum, cnt, mine, sp = 0u;
    for (;;) {
        sum = 0u; cnt = 0u; mine = 0u;
#pragma unroll
        for (unsigned j = 0; j < 16; ++j) { const unsigned c = xb_ld(&bar[XB_XCNT(j)]); sum += c; cnt += (c > 0u) ? 1u : 0u; mine = (j == x) ? c : mine; }
        if (sum == G) break;
        __builtin_amdgcn_s_sleep(1);
        if ((++sp & 255u) == 0u) { if (xb_ld(&bar[XB_TMO])) break; if (sp > XB_SPIN_CAP) { atomicAdd(&bar[XB_TMO], 1u); break; } }
    }
    nloc = mine > 0u ? mine : 1u; nx = cnt > 0u ? cnt : 1u;
}

__device__ __forceinline__ void xcd_barrier(const XcdBarrier& b) {
    asm volatile("s_waitcnt vmcnt(0)" ::: "memory");
    __syncthreads();
    if (threadIdx.x == 0) {
        unsigned* bar = b.bar;
        __builtin_amdgcn_s_waitcnt(0);
        unsigned nloc = b.st[0], nx = b.st[1];
        if (nloc == 0u) { xcd_barrier_complete(bar, b.x, nloc, nx); b.st[0] = nloc; b.st[1] = nx; }
        const unsigned old = xb_add(&bar[XB_XSUB(b.x)], 1u);
        const unsigned gen = old / nloc;
        if (old + 1u == (gen + 1u) * nloc) {
            __builtin_amdgcn_fence(__ATOMIC_RELEASE, "agent");
            asm volatile("s_waitcnt vmcnt(0)" ::: "memory");
            const unsigned og = xb_add(&bar[XB_TOP], 1u);
            const unsigned tg = og / nx;
            if (og + 1u == (tg + 1u) * nx) xb_add(&bar[XB_TOPGEN], 1u);
            else XB_SPIN(xb_ld(&bar[XB_TOPGEN]) == tg, bar);
            __builtin_amdgcn_fence(__ATOMIC_ACQUIRE, "agent");
            xb_add(&bar[XB_XGEN(b.x)], 1u);
            asm volatile("s_waitcnt vmcnt(0)" ::: "memory");
        } else {
            XB_SPIN(xb_ld(&bar[XB_XGEN(b.x)]) == gen, bar);
            __builtin_amdgcn_fence(__ATOMIC_ACQUIRE, "agent");
            asm volatile("s_waitcnt vmcnt(0)" ::: "memory");
        }
    }
    __syncthreads();
}

typedef float f32x16 __attribute__((ext_vector_type(16)));
typedef short s16x4 __attribute__((ext_vector_type(4)));
typedef float f32x2v __attribute__((ext_vector_type(2)));

struct Frame {
    LAS unsigned char* lds;
    volatile LAS unsigned* MISC;
    gu32* ctl;
    int tid, lane, wave;
    int vcu, G;
    const float *x, *c, *w_ada, *b_ada, *norm1, *w_in, *sinks, *w_pool, *pool_scale, *w_out, *norm2, *w_gate, *w_up, *w_down, *norm_f;
    const int* positions;
    float* out;
    bf16 *Win_t, *Wcat_t, *Wgu_t, *Wd_t, *XN, *U, *CAT, *H;
    float *rope, *modp, *modf;
};

__device__ __forceinline__ float wave_sum(float v) {
#pragma unroll
    for (int o = 1; o < 64; o <<= 1) v += __shfl_xor(v, o);
    return v;
}
__device__ __forceinline__ float bf_lo(unsigned w) { return __builtin_bit_cast(float, w << 16); }
__device__ __forceinline__ float bf_hi(unsigned w) { return __builtin_bit_cast(float, w & 0xffff0000u); }

__device__ __forceinline__ void p0_transpose_item(const float* W, int ldw, int k0, int n0, bf16* WT, int drow0, int ldd, int dcol0, LAS float* scr, int lane) {
#pragma unroll 8
    for (int i = 0; i < 32; ++i) { const int kk = 2 * i + (lane >> 5); scr[kk * 33 + (lane & 31)] = W[(size_t)(k0 + kk) * ldw + n0 + (lane & 31)]; }
    LDS_WAIT(); asm volatile("" ::: "memory");
    const int c = lane & 7;
#pragma unroll
    for (int j = 0; j < 4; ++j) { const int n = (lane >> 3) + 8 * j; const LAS float* s = scr + (8 * c) * 33 + n;
        v4u o; o.x = pk2(s[0 * 33], s[1 * 33]); o.y = pk2(s[2 * 33], s[3 * 33]); o.z = pk2(s[4 * 33], s[5 * 33]); o.w = pk2(s[6 * 33], s[7 * 33]);
        *(GAS v4u*)(WT + (size_t)(drow0 + n) * ldd + dcol0 + k0 + 8 * c) = o; }
    LDS_WAIT(); asm volatile("" ::: "memory");
}
__device__ __forceinline__ void p0_prologue(Frame& F) {
    LAS float* scr = (LAS float*)(F.lds + RING_OFF + F.wave * 16384);
    const int gw = F.vcu * NWAVES + F.wave, NGW = F.G * NWAVES, lane = F.lane;
    constexpr int I_IN = (D / 64) * (NIN / 32), I_OUT = (512 / 64) * (D / 32), I_G = (D / 64) * (FF / 32), I_D = (FF / 64) * (D / 32);
    constexpr int I_T = I_IN + I_OUT + 2 * I_G + I_D;
    constexpr int I_FOLD = 4 * 16 * 16;
    constexpr int I_MOD = 96 * 8;
    constexpr int I_ROPE = M / 2;
    constexpr int NITEMS = I_MOD + I_T + I_FOLD + I_ROPE;
    for (int it = gw; it < NITEMS; it += NGW) {
        int r = it;
        if (r < I_MOD) {
            const int cg = r % 96, kc = r / 96, n = cg * 64 + lane; float a0 = 0.f, a1 = 0.f;
            const float* wp = F.w_ada + (size_t)(kc * 128) * NMOD + n;
#pragma unroll 8
            for (int k = 0; k < 128; ++k) { const float w = wp[(size_t)k * NMOD]; const float c0 = F.c[kc * 128 + k], c1 = F.c[D + kc * 128 + k];
                const float s0 = c0 / (1.0f + __expf(-c0)), s1 = c1 / (1.0f + __expf(-c1)); a0 += s0 * w; a1 += s1 * w; }
            F.modp[(size_t)(kc * 2 + 0) * NMOD + n] = a0; F.modp[(size_t)(kc * 2 + 1) * NMOD + n] = a1;
            continue; }
        r -= I_MOD;
        if (r < I_T) {
            if (r < I_IN) { const int nblk = NIN / 32, kb = r / nblk, nb = r % nblk; p0_transpose_item(F.w_in, NIN, 64 * kb, 32 * nb, F.Win_t, 32 * nb, D, 0, scr, lane); continue; } r -= I_IN;
            if (r < I_OUT) { const int nblk = D / 32, kb = r / nblk, nb = r % nblk; p0_transpose_item(F.w_out, D, 64 * kb, 32 * nb, F.Wcat_t, 32 * nb, D, 0, scr, lane); continue; } r -= I_OUT;
            if (r < 2 * I_G) { const int up = r >= I_G; if (up) r -= I_G; const int nblk = FF / 32, kb = r / nblk, nb = r % nblk, n0 = 32 * nb;
                p0_transpose_item(up ? F.w_up : F.w_gate, FF, 64 * kb, n0, F.Wgu_t, 256 * (n0 / 128) + (n0 % 128) + (up ? 128 : 0), D, 0, scr, lane); continue; } r -= 2 * I_G;
            { const int nblk = D / 32, kb = r / nblk, nb = r % nblk; p0_transpose_item(F.w_down, D, 64 * kb, 32 * nb, F.Wd_t, 32 * nb, FF, 0, scr, lane); continue; }
        }
        r -= I_T;
        if (r < I_FOLD) {
            const int g = r >> 8, cb = (r >> 4) & 15, nb = r & 15, n = nb * 64 + lane; float a[8];
#pragma unroll
            for (int j = 0; j < 8; ++j) a[j] = 0.f;
            const float* wp = F.w_pool + (size_t)(g * 128 + cb * 8) * 128; const float* wo = F.w_out + (size_t)(512 + g * 128) * D + n; const float* ps = F.pool_scale + g * 128;
#pragma unroll 4
            for (int d = 0; d < 128; ++d) { const float v = wo[(size_t)d * D] * ps[d];
#pragma unroll
                for (int j = 0; j < 8; ++j) a[j] += wp[j * 128 + d] * v; }
            v4u o; o.x = pk2(a[0], a[1]); o.y = pk2(a[2], a[3]); o.z = pk2(a[4], a[5]); o.w = pk2(a[6], a[7]);
            *(GAS v4u*)(F.Wcat_t + (size_t)n * D + 512 + g * 128 + cb * 8) = o;
            continue; }
        r -= I_FOLD;
        {
            const int row = 2 * r + (lane >> 5), i = lane & 31;
            const float inv_freq = (float)exp2(-(double)i * (13.287712379549449 / 32.0));
            const float ang = (float)F.positions[row] * inv_freq;
            const double rev = (double)ang * 0.15915494309189535; const float fr = (float)(rev - rint(rev));
            f32x2v cs; cs.x = __builtin_amdgcn_cosf(fr); cs.y = __builtin_amdgcn_sinf(fr);
            *(GAS f32x2v*)(F.rope + ((size_t)row * 32 + i) * 2) = cs;
        }
    }
}

template <bool FROM_PARTIALS> __device__ __forceinline__ void build_mod_tables(Frame& F, const float* g, int shift_off, int scale_off, LAS float* A, LAS float* S) {
    for (int i = F.tid; i < 2 * D; i += NWAVES * 64) { const int b = i >> 10, k = i & (D - 1); float sh, sc;
        if (FROM_PARTIALS) { sh = F.b_ada[shift_off + k]; sc = F.b_ada[scale_off + k];
#pragma unroll
            for (int kc = 0; kc < 8; ++kc) { sh += F.modp[(size_t)(kc * 2 + b) * NMOD + shift_off + k]; sc += F.modp[(size_t)(kc * 2 + b) * NMOD + scale_off + k]; } }
        else { sh = F.modf[b * NMOD + shift_off + k]; sc = F.modf[b * NMOD + scale_off + k]; }
        A[i] = g[k] * (1.0f + sc); S[i] = sh; }
    if (FROM_PARTIALS) { const int idx = blockIdx.x * 512 + F.tid;
        if (idx < 2 * NMOD) { const int b = idx / NMOD, n = idx % NMOD; float v = F.b_ada[n];
#pragma unroll
            for (int kc = 0; kc < 8; ++kc) v += F.modp[(size_t)(kc * 2 + b) * NMOD + n];
            F.modf[idx] = v; } }
    __syncthreads();
}
__device__ __forceinline__ void norm_mod_rows(Frame& F, const float* X, bf16* XN, const LAS float* A, const LAS float* S) {
    const int gw = F.vcu * NWAVES + F.wave, NGW = F.G * NWAVES;
    for (int m = gw; m < M; m += NGW) { const int b = m / SEQ;
        const GAS f32x4* xr = (const GAS f32x4*)(X + (size_t)m * D) + F.lane;
        f32x4 v[4]; float s = 0.f;
#pragma unroll
        for (int j = 0; j < 4; ++j) { v[j] = xr[64 * j]; s += (v[j].x * v[j].x + v[j].y * v[j].y) + (v[j].z * v[j].z + v[j].w * v[j].w); }
        const float rstd = 1.0f / sqrtf(wave_sum(s) * (1.f / D) + RMS_EPS);
        GAS unsigned long long* o8 = (GAS unsigned long long*)(XN + (size_t)m * D) + F.lane;
#pragma unroll
        for (int j = 0; j < 4; ++j) { const f32x4 a = *(const LAS f32x4*)(A + b * D + 256 * j + 4 * F.lane), sh = *(const LAS f32x4*)(S + b * D + 256 * j + 4 * F.lane);
            const f32x4 o = v[j] * rstd * a + sh;
            o8[64 * j] = (unsigned long long)pk2(o.x, o.y) | ((unsigned long long)pk2(o.z, o.w) << 32); }
    }
}
__device__ __forceinline__ void final_norm_rows(Frame& F, float* X, const float* g) {
    const int gw = F.vcu * NWAVES + F.wave, NGW = F.G * NWAVES;
    f32x4 gv[4];
#pragma unroll
    for (int j = 0; j < 4; ++j) gv[j] = *(const f32x4*)(g + 256 * j + 4 * F.lane);
    for (int m = gw; m < M; m += NGW) {
        GAS f32x4* xr = (GAS f32x4*)(X + (size_t)m * D) + F.lane;
        f32x4 v[4]; float s = 0.f;
#pragma unroll
        for (int j = 0; j < 4; ++j) { v[j] = xr[64 * j]; s += (v[j].x * v[j].x + v[j].y * v[j].y) + (v[j].z * v[j].z + v[j].w * v[j].w); }
        const float rstd = 1.0f / sqrtf(wave_sum(s) * (1.f / D) + RMS_EPS);
#pragma unroll
        for (int j = 0; j < 4; ++j) xr[64 * j] = v[j] * rstd * gv[j];
    }
}

constexpr int AT_K = 0, AT_V = 24576, AT_WS = 49152, AT_OST = 51200;
__device__ __forceinline__ int crow(int r, int hi) { return (r & 3) + 8 * (r >> 2) + 4 * hi; }
__device__ __forceinline__ void rope8(unsigned (&lo)[4], unsigned (&hi)[4], const float* tab, float scale) {
    f32x4 t[4];
#pragma unroll
    for (int j = 0; j < 4; ++j) t[j] = *(const f32x4*)(tab + 4 * j);
#pragma unroll
    for (int j = 0; j < 4; ++j) { const float c0 = t[j].x, s0 = t[j].y, c1 = t[j].z, s1 = t[j].w;
        const float a0 = bf_lo(lo[j]), a1 = bf_hi(lo[j]), b0 = bf_lo(hi[j]), b1 = bf_hi(hi[j]);
        lo[j] = pk2((a0 * c0 - b0 * s0) * scale, (a1 * c1 - b1 * s1) * scale);
        hi[j] = pk2((b0 * c0 + a0 * s0) * scale, (b1 * c1 + a1 * s1) * scale); }
}
__device__ __forceinline__ void attn_pool_unit(Frame& F, int b, int kvh, int tile) {
    LAS unsigned char* shm = F.lds + RING_OFF;
    const int tid = F.tid, lane = F.lane, wid = F.wave, r32 = lane & 31, hi = lane >> 5;
    const int t0 = tile * 64; const size_t rowbase = (size_t)b * SEQ;
    const bf16* U = F.U;
    for (int idx = tid; idx < 768; idx += NWAVES * 64) {
        const int kt = idx >> 8, row = (idx >> 2) & 63, c = idx & 3;
        int kp = t0 - 128 + kt * 64 + row; kp = kp < 0 ? 0 : kp;
        const bf16* src = U + (rowbase + kp) * NIN + COL_K + kvh * HD + c * 8;
        const v4u l4 = *(const GAS v4u*)src, h4 = *(const GAS v4u*)(src + 32);
        unsigned lo[4] = {l4.x, l4.y, l4.z, l4.w}, hh[4] = {h4.x, h4.y, h4.z, h4.w};
        rope8(lo, hh, F.rope + ((rowbase + kp) * 32 + c * 8) * 2, 1.0f);
        *(LAS v4u*)(shm + AT_K + kt * 8192 + c * 1024 + row * 16) = (v4u){lo[0], lo[1], lo[2], lo[3]};
        *(LAS v4u*)(shm + AT_K + kt * 8192 + (c + 4) * 1024 + row * 16) = (v4u){hh[0], hh[1], hh[2], hh[3]};
    }
    for (int idx = tid; idx < 1536; idx += NWAVES * 64) {
        const int kt = idx >> 9, row = (idx >> 3) & 63, c = idx & 7;
        int kp = t0 - 128 + kt * 64 + row; kp = kp < 0 ? 0 : kp;
        const v4u v = *(const GAS v4u*)(U + (rowbase + kp) * NIN + COL_V + kvh * HD + c * 8);
        *(LAS v4u*)(shm + AT_V + kt * 8192 + (c >> 2) * 4096 + (row >> 4) * 1024 + (row & 15) * 64 + (c & 3) * 16) = v;
    }
    const int head = kvh * GROUP + (wid >> 1), half = wid & 1;
    const size_t qrow = rowbase + t0 + 32 * half + r32;
    bf16x8 qr[4];
    { const bf16* qp = U + qrow * NIN + head * HD + hi * 8;
      const v4u q0 = *(const GAS v4u*)qp, q1 = *(const GAS v4u*)(qp + 16), q2 = *(const GAS v4u*)(qp + 32), q3 = *(const GAS v4u*)(qp + 48);
      unsigned a0[4] = {q0.x, q0.y, q0.z, q0.w}, a1[4] = {q1.x, q1.y, q1.z, q1.w}, a2[4] = {q2.x, q2.y, q2.z, q2.w}, a3[4] = {q3.x, q3.y, q3.z, q3.w};
      rope8(a0, a2, F.rope + (qrow * 32 + hi * 8) * 2, C2);
      rope8(a1, a3, F.rope + (qrow * 32 + 16 + hi * 8) * 2, C2);
      qr[0] = __builtin_bit_cast(bf16x8, (v4u){a0[0], a0[1], a0[2], a0[3]}); qr[1] = __builtin_bit_cast(bf16x8, (v4u){a1[0], a1[1], a1[2], a1[3]});
      qr[2] = __builtin_bit_cast(bf16x8, (v4u){a2[0], a2[1], a2[2], a2[3]}); qr[3] = __builtin_bit_cast(bf16x8, (v4u){a3[0], a3[1], a3[2], a3[3]}); }
    const float sink2 = F.sinks[head] * 1.4426950408889634f;
    __syncthreads();
    f32x16 s[6];
#pragma unroll
    for (int kt = 0; kt < 3; ++kt) {
        const LAS unsigned char* kb = shm + AT_K + kt * 8192 + hi * 1024 + r32 * 16;
        f32x16 p0 = {}, p1 = {};
#pragma unroll
        for (int d0 = 0; d0 < 4; ++d0) { const bf16x8 b0 = *(const LAS bf16x8*)(kb + d0 * 2048), b1 = *(const LAS bf16x8*)(kb + d0 * 2048 + 512);
            p0 = __builtin_amdgcn_mfma_f32_32x32x16_bf16(b0, qr[d0], p0, 0, 0, 0); p1 = __builtin_amdgcn_mfma_f32_32x32x16_bf16(b1, qr[d0], p1, 0, 0, 0); }
        s[2 * kt] = p0; s[2 * kt + 1] = p1;
    }
    const int qp = t0 + 32 * half + r32;
    float mx = sink2;
#pragma unroll
    for (int kt = 0; kt < 3; ++kt)
#pragma unroll
        for (int r = 0; r < 16; ++r) { const int k0 = t0 - 128 + 64 * kt + crow(r, hi), k1 = k0 + 32;
            const bool v0 = (k0 >= 0) && (k0 <= qp) && (k0 > qp - WINDOW), v1 = (k1 >= 0) && (k1 <= qp) && (k1 > qp - WINDOW);
            s[2 * kt][r] = v0 ? s[2 * kt][r] : -INFINITY; s[2 * kt + 1][r] = v1 ? s[2 * kt + 1][r] : -INFINITY;
            mx = fmaxf(mx, fmaxf(s[2 * kt][r], s[2 * kt + 1][r])); }
    mx = fmaxf(mx, __shfl_xor(mx, 32));
    float l = 0.f;
#pragma unroll
    for (int i = 0; i < 6; ++i)
#pragma unroll
        for (int r = 0; r < 16; ++r) { const float p = __builtin_amdgcn_exp2f(s[i][r] - mx); s[i][r] = p; l += p; }
    l += __shfl_xor(l, 32);
    l += __builtin_amdgcn_exp2f(sink2 - mx);
    f32x16 o[2]; o[0] = (f32x16){}; o[1] = (f32x16){};
    const int vb0 = (int)(unsigned)(uintptr_t)(shm + AT_V) + ((lane >> 4) & 1) * 32 + (lane & 3) * 8 + (4 * hi + ((lane & 15) >> 2)) * 64;
#pragma unroll
    for (int kt = 0; kt < 3; ++kt) {
        bf16x8 pa[4];
#pragma unroll
        for (int ks = 0; ks < 4; ++ks) { const f32x16& P = s[2 * kt + (ks >> 1)]; const int bb = (ks & 1) * 8;
            pa[ks] = __builtin_bit_cast(bf16x8, (v4u){pk2(P[bb], P[bb + 1]), pk2(P[bb + 2], P[bb + 3]), pk2(P[bb + 4], P[bb + 5]), pk2(P[bb + 6], P[bb + 7])}); }
        const int vb = vb0 + kt * 8192;
#pragma unroll
        for (int d0 = 0; d0 < 2; ++d0) { s16x4 lo[4], hh[4];
#pragma unroll
            for (int ks = 0; ks < 4; ++ks) {
                asm volatile("ds_read_b64_tr_b16 %0,%1 offset:%c2" : "=&v"(lo[ks]) : "v"(vb), "i"(d0 * 4096 + ks * 1024) : "memory");
                asm volatile("ds_read_b64_tr_b16 %0,%1 offset:%c2" : "=&v"(hh[ks]) : "v"(vb), "i"(d0 * 4096 + ks * 1024 + 512) : "memory"); }
            asm volatile("s_waitcnt lgkmcnt(0)" ::: "memory"); __builtin_amdgcn_sched_barrier(0);
#pragma unroll
            for (int ks = 0; ks < 4; ++ks) { const bf16x8 vf = (bf16x8){lo[ks][0], lo[ks][1], lo[ks][2], lo[ks][3], hh[ks][0], hh[ks][1], hh[ks][2], hh[ks][3]};
                o[d0] = __builtin_amdgcn_mfma_f32_32x32x16_bf16(pa[ks], vf, o[d0], 0, 0, 0); }
        }
    }
    LAS float* wsf = (LAS float*)(shm + AT_WS) + wid * 64;
    if (hi == 0) wsf[r32] = l;
    LDS_WAIT(); asm volatile("" ::: "memory");
    LAS bf16* stg = (LAS bf16*)(shm + AT_OST) + wid * 2048;
#pragma unroll
    for (int r = 0; r < 16; ++r) { const int orow = crow(r, hi); const float rl = 1.0f / wsf[orow];
        stg[orow * 64 + r32] = (bf16)f2bf(o[0][r] * rl); stg[orow * 64 + 32 + r32] = (bf16)f2bf(o[1][r] * rl); }
    LDS_WAIT(); asm volatile("" ::: "memory");
    { bf16* Ow = F.CAT + (rowbase + t0 + 32 * half) * D + head * HD;
#pragma unroll
      for (int i = 0; i < 4; ++i) { const int row = i * 8 + (lane >> 3), ch = lane & 7; const v4u v = *(const LAS v4u*)(stg + row * 64 + ch * 8); *(GAS v4u*)(Ow + (size_t)row * D + ch * 8) = v; } }
    { const int g = 2 * kvh + (wid & 1), w = 2 << g, ch0 = g * 128 + (lane & 15) * 8, tf = t0 + 4 * ((wid >> 1) * 4 + (lane >> 4));
      float sum[4][8], cur[4][8];
#pragma unroll
      for (int tt = 0; tt < 4; ++tt)
#pragma unroll
          for (int j = 0; j < 8; ++j) { sum[tt][j] = 0.f; cur[tt][j] = 0.f; }
      for (int i = 0; i < w + 3; ++i) { const int p = tf - (w - 1) + i;
          if (p >= 0) { const v4u q = *(const GAS v4u*)(U + (rowbase + p) * NIN + COL_P + ch0);
              const float v[8] = {bf_lo(q.x), bf_hi(q.x), bf_lo(q.y), bf_hi(q.y), bf_lo(q.z), bf_hi(q.z), bf_lo(q.w), bf_hi(q.w)};
#pragma unroll
              for (int tt = 0; tt < 4; ++tt) { const bool in = (i >= tt) && (i <= tt + w - 1), isc = (i == tt + w - 1);
#pragma unroll
                  for (int j = 0; j < 8; ++j) { sum[tt][j] += in ? v[j] : 0.f; cur[tt][j] = isc ? v[j] : cur[tt][j]; } } } }
#pragma unroll
      for (int tt = 0; tt < 4; ++tt) { const int t = tf + tt; const float inv = 1.0f / (float)((t + 1) < w ? (t + 1) : w); float pv_[8];
#pragma unroll
          for (int j = 0; j < 8; ++j) pv_[j] = sum[tt][j] * inv - cur[tt][j];
          *(GAS v4u*)(F.CAT + (rowbase + t) * D + 512 + ch0) = (v4u){pk2(pv_[0], pv_[1]), pk2(pv_[2], pv_[3]), pk2(pv_[4], pv_[5]), pk2(pv_[6], pv_[7])}; } }
    __syncthreads();
}

struct Args { const void* in[16]; float* out; unsigned char* ws; };
__global__ void __launch_bounds__(NWAVES * 64, 2) fwd_megakernel(Args args) {
    extern __shared__ __attribute__((aligned(16))) unsigned char lds[];
    Frame F;
    F.lds = (LAS unsigned char*)lds;
    F.MISC = (volatile LAS unsigned*)(F.lds + MISC_OFF);
    F.tid = threadIdx.x; F.lane = F.tid & 63; F.wave = __builtin_amdgcn_readfirstlane(F.tid >> 6);
    F.G = gridDim.x; { const int bx = blockIdx.x; F.vcu = (F.G % 8 == 0) ? (bx % 8) * (F.G / 8) + bx / 8 : bx; }
    unsigned char* ws = args.ws;
    F.ctl = (gu32*)(ws + WS_CTL);
    F.x = (const float*)args.in[0]; F.c = (const float*)args.in[1]; F.positions = (const int*)args.in[2]; F.w_ada = (const float*)args.in[3]; F.b_ada = (const float*)args.in[4];
    F.norm1 = (const float*)args.in[5]; F.w_in = (const float*)args.in[6]; F.sinks = (const float*)args.in[7]; F.w_pool = (const float*)args.in[8]; F.pool_scale = (const float*)args.in[9];
    F.w_out = (const float*)args.in[10]; F.norm2 = (const float*)args.in[11]; F.w_gate = (const float*)args.in[12]; F.w_up = (const float*)args.in[13]; F.w_down = (const float*)args.in[14];
    F.norm_f = (const float*)args.in[15]; F.out = args.out;
    F.Win_t = (bf16*)(ws + WS_WIN); F.Wcat_t = (bf16*)(ws + WS_WCAT); F.Wgu_t = (bf16*)(ws + WS_WGU); F.Wd_t = (bf16*)(ws + WS_WD);
    F.XN = (bf16*)(ws + WS_XN); F.U = (bf16*)(ws + WS_U); F.CAT = (bf16*)(ws + WS_CAT); F.H = (bf16*)(ws + WS_H);
    F.rope = (float*)(ws + WS_ROPE); F.modp = (float*)(ws + WS_MODP); F.modf = (float*)(ws + WS_MODF);
    for (int u = F.tid; u < (LDS_BYTES - LDSCTL_OFF) / 4; u += NWAVES * 64) ((LAS unsigned*)(F.lds + LDSCTL_OFF))[u] = 0u;
    __syncthreads();
    XcdBarrier bar = xcd_barrier_post((unsigned*)(F.ctl + CW_BAR), F.MISC + 8);
#define GRID_BAR() xcd_barrier(bar)
    LAS float* TA = (LAS float*)(F.lds + RING_OFF); LAS float* TS = TA + 2 * D;

    p0_prologue(F);
    GRID_BAR();
    build_mod_tables<true>(F, F.norm1, 0 * D, 1 * D, TA, TS);
    norm_mod_rows(F, F.x, F.XN, TA, TS);
    GRID_BAR();
    { pg8::Gemm g{F.XN, F.Win_t, M, NIN, D}; pg8::StaticOrder S; S.init(M, NIN, F.G, (int)blockIdx.x);
      pg8::EpiStoreBf16 E{F.U, NIN};
      pg8::gemm_phase<pg8::EpiStoreBf16, pg8::StaticOrder, PG8_ALIGN, PG8_SP2>(F.lds + RING_OFF, g, S, E); }
    GRID_BAR();
    { const int per = (BATCH * NKVH * (SEQ / 64) + F.G - 1) / F.G;
      for (int i = 0; i < per; ++i) { const int uid = F.vcu * per + i; if (uid < BATCH * NKVH * (SEQ / 64)) attn_pool_unit(F, uid / (NKVH * (SEQ / 64)), (uid / (SEQ / 64)) % NKVH, uid % (SEQ / 64)); } }
    GRID_BAR();
    { pg8::Gemm g{F.CAT, F.Wcat_t, M, D, D}; pg8::StaticOrder S; S.init(M, D, F.G, (int)blockIdx.x);
      pg8::EpiResGateF32 E{F.x, F.out, F.modf + 2 * D, NMOD, D, SEQ};
      pg8::gemm_phase<pg8::EpiResGateF32, pg8::StaticOrder, PG8_ALIGN, PG8_SP2>(F.lds + RING_OFF, g, S, E); }
    GRID_BAR();
    build_mod_tables<false>(F, F.norm2, 3 * D, 4 * D, TA, TS);
    norm_mod_rows(F, F.out, F.XN, TA, TS);
    GRID_BAR();
    { pg8::Gemm g{F.XN, F.Wgu_t, M, NGU, D}; pg8::StaticOrder S; S.init(M, NGU, F.G, (int)blockIdx.x);
      pg8::EpiSwiGLU E{F.H, FF};
      pg8::gemm_phase<pg8::EpiSwiGLU, pg8::StaticOrder, PG8_ALIGN, PG8_SP2>(F.lds + RING_OFF, g, S, E); }
    GRID_BAR();
    { pg8::Gemm g{F.H, F.Wd_t, M, D, FF}; pg8::StaticOrder S; S.init(M, D, F.G, (int)blockIdx.x);
      pg8::EpiResGateF32 E{F.out, F.out, F.modf + 5 * D, NMOD, D, SEQ};
      pg8::gemm_phase<pg8::EpiResGateF32, pg8::StaticOrder, PG8_ALIGN, PG8_SP2>(F.lds + RING_OFF, g, S, E); }
    GRID_BAR();
    final_norm_rows(F, F.out, F.norm_f);
}

extern "C" void kernel_launch(void* const* d_in, const int* in_sizes, int n_in, void* d_out, int out_size, void* d_ws, size_t ws_size, hipStream_t stream) {
    static int grid = 0;
    if (grid == 0) {
        if (n_in != 16 || in_sizes[0] != M * D || out_size != M * D || ws_size < WS_END) { fprintf(stderr, "kernel_launch: unexpected shapes (n_in %d, in0 %d, out %d, ws %zu); nothing launched\n", n_in, n_in > 0 ? in_sizes[0] : -1, out_size, ws_size); grid = -1; return; }
        int dev = 0, cus = 0, per_cu = 0;
        if (hipGetDevice(&dev) != hipSuccess || hipDeviceGetAttribute(&cus, hipDeviceAttributeMultiprocessorCount, dev) != hipSuccess) { grid = -1; return; }
        if (hipFuncSetAttribute((const void*)fwd_megakernel, hipFuncAttributeMaxDynamicSharedMemorySize, LDS_BYTES) != hipSuccess) { fprintf(stderr, "kernel_launch: hipFuncSetAttribute failed\n"); grid = -1; return; }
        if (hipOccupancyMaxActiveBlocksPerMultiprocessor(&per_cu, (const void*)fwd_megakernel, NWAVES * 64, LDS_BYTES) != hipSuccess || per_cu < 1) { fprintf(stderr, "kernel_launch: occupancy query reports %d workgroups per CU\n", per_cu); per_cu = 1; }
        (void)hipGetLastError();
        grid = cus;
    }
    if (grid < 0) return;
    if (hipMemsetAsync((char*)d_ws + WS_CTL, 0, CTL_ZERO_BYTES, stream) != hipSuccess) { fprintf(stderr, "kernel_launch: hipMemsetAsync failed\n"); return; }
    Args a{};
    for (int i = 0; i < 16; ++i) a.in[i] = d_in[i];
    a.out = (float*)d_out; a.ws = (unsigned char*)d_ws;
    hipLaunchKernelGGL(fwd_megakernel, dim3(grid), dim3(NWAVES * 64), LDS_BYTES, stream, a);
    const hipError_t le = hipPeekAtLastError();
    if (le != hipSuccess) fprintf(stderr, "kernel_launch: launch failed: %s\n", hipGetErrorName(le));
}
```
